# Optimizing an MI355X kernel written in HIP

```python
import math
import jax
import jax.numpy as jnp
from jax import lax
import numpy as np

D_MODEL = 1024
BATCH = 2
SEQ = 8192
DEPTH = 1

HEAD_DIM = 64
SB_HEADS = 8
DIL_PATTERNS = ((128, 1), (512, 4), (2048, 16))
DIL_HEADS_PER_GROUP = 4
DIL_HEADS = DIL_HEADS_PER_GROUP * len(DIL_PATTERNS)
Q_BLOCK = 128
SB_WIDTH = SB_HEADS * HEAD_DIM
DIL_WIDTH = DIL_HEADS * HEAD_DIM
DIL_OUT_WIDTH = DIL_HEADS_PER_GROUP * HEAD_DIM
IN_SPLITS = (SB_WIDTH, SB_WIDTH, SB_WIDTH, DIL_WIDTH, DIL_WIDTH, DIL_WIDTH, D_MODEL, D_MODEL)
IN_WIDTH = int(sum(IN_SPLITS))
IN_SPLIT_POINTS = tuple(int(v) for v in np.cumsum(IN_SPLITS)[:-1])

REL_BUCKETS = 32
REL_MAX_DISTANCE = 2048

N_EXPERTS = 256
TOP_K = 8
N_GROUPS = 8
TOPK_GROUPS = 4
EXPERT_HIDDEN = 256
SHARED_HIDDEN = 256
ROUTED_SCALE = 2.5
EXPERT_BLOCK = 128

LN_EPS = 1e-5
DN_ALPHA = (2 * DEPTH) ** 0.25
DN_BETA = (8 * DEPTH) ** -0.25

kernel_name = "hybrid_stickbreak_dilated_moe_block"


def _layer_norm(x, g, b):
    xf = x.astype(jnp.float32)
    mu = jnp.mean(xf, axis=-1, keepdims=True)
    var = jnp.mean(jnp.square(xf - mu), axis=-1, keepdims=True)
    y = (xf - mu) * lax.rsqrt(var + LN_EPS)
    return (y * g.astype(jnp.float32) + b.astype(jnp.float32)).astype(x.dtype)


def _split_heads(t, n_heads):
    b, s, _ = t.shape
    return t.reshape(b, s, n_heads, HEAD_DIM).transpose(0, 2, 1, 3)


def _merge_heads(t):
    b, h, s, d = t.shape
    return t.transpose(0, 2, 1, 3).reshape(b, s, h * d)


def _to_query_blocks(t):
    b, h, s, d = t.shape
    return t.reshape(b, h, s // Q_BLOCK, Q_BLOCK, d).transpose(2, 0, 1, 3, 4)


def _from_query_blocks(t):
    nb, b, h, q, d = t.shape
    return t.transpose(1, 2, 0, 3, 4).reshape(b, h, nb * q, d)


def _stick_breaking_attention(q, k, v):
    s = q.shape[2]
    scale = 1.0 / math.sqrt(HEAD_DIM)
    key_pos = jnp.arange(s, dtype=jnp.int32)

    def one_block(args):
        q_blk, blk = args
        q_pos = blk * Q_BLOCK + jnp.arange(Q_BLOCK, dtype=jnp.int32)
        before = key_pos[None, :] < q_pos[:, None]
        z = jnp.einsum('bhqd,bhkd->bhqk', q_blk, k).astype(jnp.float32) * scale
        log_keep = jnp.where(before, jax.nn.log_sigmoid(-z), 0.0)
        log_keep_between = lax.cumsum(log_keep, axis=3, reverse=True) - log_keep
        weight = jnp.where(before, jnp.exp(jax.nn.log_sigmoid(z) + log_keep_between), 0.0)
        return jnp.einsum('bhqk,bhkd->bhqd', weight.astype(v.dtype), v)

    n_blocks = s // Q_BLOCK
    out = lax.map(one_block, (_to_query_blocks(q), jnp.arange(n_blocks, dtype=jnp.int32)))
    return _from_query_blocks(out)


def _rel_bucket(dist):
    max_exact = REL_BUCKETS // 2
    d = jnp.maximum(dist, 1).astype(jnp.float32)
    large = max_exact + (jnp.log(d / max_exact) / math.log(REL_MAX_DISTANCE / max_exact)
                         * (REL_BUCKETS - max_exact)).astype(jnp.int32)
    large = jnp.minimum(large, REL_BUCKETS - 1)
    return jnp.where(dist < max_exact, dist, large)


def _dilated_attention(q, k, v, rel_bias):
    s = q.shape[2]
    scale = 1.0 / math.sqrt(HEAD_DIM)
    n_blocks = s // Q_BLOCK
    groups = []
    for g, (window, dilation) in enumerate(DIL_PATTERNS):
        offsets = jnp.arange(window // dilation + 1, dtype=jnp.int32) * dilation
        heads = slice(g * DIL_HEADS_PER_GROUP, (g + 1) * DIL_HEADS_PER_GROUP)
        bias = rel_bias[_rel_bucket(offsets)][:, heads].T.astype(jnp.float32)
        groups.append((heads, offsets, bias, k[:, heads], v[:, heads]))

    def one_block(args):
        q_blk, blk = args
        q_pos = blk * Q_BLOCK + jnp.arange(Q_BLOCK, dtype=jnp.int32)
        outs, lses = [], []
        for heads, offsets, bias, k_g, v_g in groups:
            idx = q_pos[:, None] - offsets[None, :]
            valid = idx >= 0
            idx = jnp.maximum(idx, 0)
            k_sel = jnp.take(k_g, idx, axis=2)
            v_sel = jnp.take(v_g, idx, axis=2)
            logits = (jnp.einsum('bhqd,bhqmd->bhqm', q_blk[:, heads], k_sel).astype(jnp.float32) * scale
                      + bias[:, None, :])
            logits = jnp.where(valid, logits, -jnp.inf)
            lse = jax.nn.logsumexp(logits, axis=-1)
            probs = jnp.exp(logits - lse[..., None])
            outs.append(jnp.einsum('bhqm,bhqmd->bhqd', probs.astype(v_g.dtype), v_sel).astype(jnp.float32))
            lses.append(lse)
        mix = jax.nn.softmax(jnp.stack(lses), axis=0)
        out = jnp.sum(mix[..., None] * jnp.stack(outs), axis=0)
        return out.astype(q_blk.dtype)

    out = lax.map(one_block, (_to_query_blocks(q), jnp.arange(n_blocks, dtype=jnp.int32)))
    return _from_query_blocks(out)


def _mixer(h, w_in, b_gate, w_br_sb, w_br_dil, w_out, rel_bias):
    proj = jnp.einsum('bsd,df->bsf', h, w_in)
    q_sb, k_sb, v_sb, q_dl, k_dl, v_dl, g_sb, g_dl = jnp.split(proj, IN_SPLIT_POINTS, axis=-1)
    o_sb = _stick_breaking_attention(_split_heads(q_sb, SB_HEADS), _split_heads(k_sb, SB_HEADS),
                                     _split_heads(v_sb, SB_HEADS))
    o_dl = _dilated_attention(_split_heads(q_dl, DIL_HEADS), _split_heads(k_dl, DIL_HEADS),
                              _split_heads(v_dl, DIL_HEADS), rel_bias)
    gates = jax.nn.sigmoid(jnp.concatenate([g_sb, g_dl], axis=-1) + b_gate)
    gate_sb, gate_dl = jnp.split(gates, 2, axis=-1)
    merged = (gate_sb * jnp.einsum('bsf,fd->bsd', _merge_heads(o_sb), w_br_sb)
              + gate_dl * jnp.einsum('bsf,fd->bsd', _merge_heads(o_dl), w_br_dil))
    return jnp.einsum('bsd,de->bse', merged, w_out)


def _route(h_flat, w_router, router_bias):
    n_tok = h_flat.shape[0]
    scores = jax.nn.sigmoid(h_flat.astype(jnp.float32) @ w_router.astype(jnp.float32))
    biased = scores + router_bias.astype(jnp.float32)
    grp = biased.reshape(n_tok, N_GROUPS, N_EXPERTS // N_GROUPS)
    grp_score = jnp.sum(lax.top_k(grp, 2)[0], axis=-1)
    _, top_groups = lax.top_k(grp_score, TOPK_GROUPS)
    grp_mask = jnp.any(top_groups[..., None] == jnp.arange(N_GROUPS, dtype=top_groups.dtype), axis=1)
    expert_mask = jnp.repeat(grp_mask, N_EXPERTS // N_GROUPS, axis=1)
    _, idx = lax.top_k(jnp.where(expert_mask, biased, -jnp.inf), TOP_K)
    w = jnp.take_along_axis(scores, idx, axis=1)
    w = w / jnp.sum(w, axis=-1, keepdims=True) * ROUTED_SCALE
    return idx.astype(jnp.int32), w


def _routed_experts(h_flat, idx, w, w_gate_e, w_up_e, w_down_e):
    n_tok, d = h_flat.shape
    n_assign = n_tok * TOP_K
    e_flat = idx.reshape(-1)
    tok_flat = jnp.arange(n_assign, dtype=jnp.int32) // TOP_K
    g_flat = w.reshape(-1)
    order = jnp.argsort(e_flat)
    e_sorted = e_flat[order]
    counts = jnp.zeros((N_EXPERTS,), jnp.int32).at[e_flat].add(1)
    padded = ((counts + EXPERT_BLOCK - 1) // EXPERT_BLOCK) * EXPERT_BLOCK
    starts = jnp.cumsum(counts) - counts
    padded_ends = jnp.cumsum(padded)
    padded_starts = padded_ends - padded
    rank = jnp.arange(n_assign, dtype=jnp.int32) - starts[e_sorted]
    dest = padded_starts[e_sorted] + rank
    n_blocks = (n_assign + EXPERT_BLOCK - 1) // EXPERT_BLOCK + N_EXPERTS
    n_slots = n_blocks * EXPERT_BLOCK
    slot_tok = jnp.zeros((n_slots,), jnp.int32).at[dest].set(tok_flat[order])
    slot_gate = jnp.zeros((n_slots,), g_flat.dtype).at[dest].set(g_flat[order])
    block_start = jnp.arange(n_blocks, dtype=jnp.int32) * EXPERT_BLOCK
    block_expert = jnp.minimum(jnp.searchsorted(padded_ends, block_start, side='right'),
                               N_EXPERTS - 1).astype(jnp.int32)

    def run_block(args):
        toks, e = args
        xb = h_flat[toks]
        hid = jax.nn.silu(xb @ w_gate_e[e]) * (xb @ w_up_e[e])
        return hid @ w_down_e[e]

    y = lax.map(run_block, (slot_tok.reshape(n_blocks, EXPERT_BLOCK), block_expert))
    y = y.reshape(n_slots, d) * slot_gate[:, None]
    return jax.ops.segment_sum(y, slot_tok, num_segments=n_tok).astype(h_flat.dtype)


def _moe(h, w_router, router_bias, w_gate_e, w_up_e, w_down_e, w_gate_s, w_up_s, w_down_s):
    b, s, d = h.shape
    h_flat = h.reshape(b * s, d)
    idx, w = _route(h_flat, w_router, router_bias)
    routed = _routed_experts(h_flat, idx, w, w_gate_e, w_up_e, w_down_e)
    shared = (jax.nn.silu(h_flat @ w_gate_s) * (h_flat @ w_up_s)) @ w_down_s
    return (routed + shared).reshape(b, s, d)


def setup_inputs(seed: int = 0) -> dict:
    key = jax.random.key(seed)
    ks = jax.random.split(key, 21)
    L, D, E, H, HS = DEPTH, D_MODEL, N_EXPERTS, EXPERT_HIDDEN, SHARED_HIDDEN
    f32 = jnp.float32
    col_scale = jnp.concatenate([
        jnp.full((n,), c, f32) for n, c in zip(
            IN_SPLITS, (1.0, 1.0, DN_BETA, 1.0, 1.0, DN_BETA, 1.0, 1.0))]) * D ** -0.5
    return {
        "x": jax.random.normal(ks[0], (BATCH, SEQ, D), f32),
        "ln_in_g": 1.0 + 0.02 * jax.random.normal(ks[1], (D,), f32),
        "ln_in_b": 0.02 * jax.random.normal(ks[2], (D,), f32),
        "rel_bias": 0.2 * jax.random.normal(ks[3], (REL_BUCKETS, DIL_HEADS), f32),
        "w_in": jax.random.normal(ks[4], (L, D, IN_WIDTH), f32) * col_scale,
        "b_gate": 0.02 * jax.random.normal(ks[5], (L, 2 * D), f32),
        "w_br_sb": jax.random.normal(ks[6], (L, SB_WIDTH, D), f32) * (DN_BETA * SB_WIDTH ** -0.5),
        "w_br_dil": jax.random.normal(ks[7], (L, DIL_OUT_WIDTH, D), f32) * (DN_BETA * DIL_OUT_WIDTH ** -0.5),
        "w_out": jax.random.normal(ks[8], (L, D, D), f32) * (DN_BETA * D ** -0.5),
        "ln1_g": 1.0 + 0.02 * jax.random.normal(ks[9], (L, D), f32),
        "ln1_b": 0.02 * jax.random.normal(ks[10], (L, D), f32),
        "w_router": jax.random.normal(ks[11], (L, D, E), f32) * D ** -0.5,
        "router_bias": 0.01 * jax.random.normal(ks[12], (L, E), f32),
        "w_gate_e": jax.random.normal(ks[13], (L, E, D, H), f32) * (DN_BETA * D ** -0.5),
        "w_up_e": jax.random.normal(ks[14], (L, E, D, H), f32) * (DN_BETA * D ** -0.5),
        "w_down_e": jax.random.normal(ks[15], (L, E, H, D), f32) * (DN_BETA * H ** -0.5),
        "w_gate_s": jax.random.normal(ks[16], (L, D, HS), f32) * (DN_BETA * D ** -0.5),
        "w_up_s": jax.random.normal(ks[17], (L, D, HS), f32) * (DN_BETA * D ** -0.5),
        "w_down_s": jax.random.normal(ks[18], (L, HS, D), f32) * (DN_BETA * HS ** -0.5),
        "ln2_g": 1.0 + 0.02 * jax.random.normal(ks[19], (L, D), f32),
        "ln2_b": 0.02 * jax.random.normal(ks[20], (L, D), f32),
    }


def reference(x, ln_in_g, ln_in_b, rel_bias, w_in, b_gate, w_br_sb, w_br_dil, w_out, ln1_g, ln1_b,
              w_router, router_bias, w_gate_e, w_up_e, w_down_e, w_gate_s, w_up_s, w_down_s,
              ln2_g, ln2_b):
    h = _layer_norm(x, ln_in_g, ln_in_b)
    for l in range(DEPTH):
        mix = _mixer(h, w_in[l], b_gate[l], w_br_sb[l], w_br_dil[l], w_out[l], rel_bias)
        h = _layer_norm(DN_ALPHA * h + mix, ln1_g[l], ln1_b[l])
        ffn = _moe(h, w_router[l], router_bias[l], w_gate_e[l], w_up_e[l], w_down_e[l],
                   w_gate_s[l], w_up_s[l], w_down_s[l])
        h = _layer_norm(DN_ALPHA * h + ffn, ln2_g[l], ln2_b[l])
    return h
```

```cpp
#include <hip/hip_runtime.h>
#include <stdint.h>
#include <stdio.h>
#include <math.h>

constexpr int T = 16384, D = 1024, SEQ = 8192;
constexpr int INW = 5888;
constexpr int C_QSB = 0, C_KSB = 512, C_VSB = 1024, C_QDL = 1536, C_KDL = 2304, C_VDL = 3072, C_GSB = 3840, C_GDL = 4864;
constexpr int NEXP = 256, TOPK = 8, EH = 256;
constexpr float ALPHA = 1.189207115002721f;
constexpr float LN_EPS = 1e-5f;
constexpr int NTHR = 512, NWV = 8;

constexpr size_t MiB = 1u << 20;
constexpr size_t WS_H = 0;
constexpr size_t WS_PROJ = 64 * MiB;
constexpr size_t WS_OSB = 450 * MiB;
constexpr size_t WS_ODL = 482 * MiB;
constexpr size_t WS_MERGED = 498 * MiB;
constexpr size_t WS_Y = 64 * MiB;
constexpr size_t WS_LOGITS = 668 * MiB;
constexpr size_t WS_LIST = 684 * MiB;
constexpr size_t WS_CNT = 716 * MiB;
constexpr size_t WS_BIAS = 716 * MiB + 4096;
constexpr size_t WS_END = 717 * MiB;

struct P {
    const float *x, *ln_in_g, *ln_in_b, *rel_bias, *w_in, *b_gate, *w_br_sb, *w_br_dil, *w_out, *ln1_g, *ln1_b,
        *w_router, *router_bias, *w_gate_e, *w_up_e, *w_down_e, *w_gate_s, *w_up_s, *w_down_s, *ln2_g, *ln2_b;
    float* out;
    unsigned char* ws;
};

__device__ __forceinline__ float wave_sum(float v) {
#pragma unroll
    for (int o = 1; o < 64; o <<= 1) v += __shfl_xor(v, o);
    return v;
}

__device__ void ln_rows(const float* in, float* out, const float* g, const float* b, int gw, int ngw, int lane) {
    for (int m = gw; m < T; m += ngw) {
        const float4* xr = (const float4*)(in + (size_t)m * D) + lane;
        float4 v[4]; float s = 0.f;
#pragma unroll
        for (int j = 0; j < 4; ++j) { v[j] = xr[64 * j]; s += (v[j].x + v[j].y) + (v[j].z + v[j].w); }
        const float mean = wave_sum(s) * (1.f / D); float s2 = 0.f;
#pragma unroll
        for (int j = 0; j < 4; ++j) { v[j].x -= mean; v[j].y -= mean; v[j].z -= mean; v[j].w -= mean; s2 += (v[j].x * v[j].x + v[j].y * v[j].y) + (v[j].z * v[j].z + v[j].w * v[j].w); }
        const float rstd = rsqrtf(wave_sum(s2) * (1.f / D) + LN_EPS);
        float4* o = (float4*)(out + (size_t)m * D) + lane;
#pragma unroll
        for (int j = 0; j < 4; ++j) { const float4 gg = ((const float4*)g)[lane + 64 * j], bb = ((const float4*)b)[lane + 64 * j];
            float4 r; r.x = v[j].x * rstd * gg.x + bb.x; r.y = v[j].y * rstd * gg.y + bb.y; r.z = v[j].z * rstd * gg.z + bb.z; r.w = v[j].w * rstd * gg.w + bb.w; o[64 * j] = r; }
    }
}

template <class Epi>
__device__ void gemm_f32(const float* A, int lda, const float* B, int ldb, int M, int N, int K, float* smem, const Epi& epi) {
    float (*As)[132] = (float (*)[132])smem;
    float (*Bs)[128] = (float (*)[128])(smem + 16 * 132);
    const int tid = threadIdx.x, tx = tid & 31, ty = tid >> 5;
    const int ntm = M / 128, ntn = N / 128;
    for (int u = blockIdx.x; u < ntm * ntn; u += gridDim.x) {
        const int m0 = (u / ntn) * 128, n0 = (u % ntn) * 128;
        float acc[8][4];
#pragma unroll
        for (int i = 0; i < 8; ++i)
#pragma unroll
            for (int j = 0; j < 4; ++j) acc[i][j] = 0.f;
        for (int k0 = 0; k0 < K; k0 += 16) {
            { const int r = tid >> 2, kq = (tid & 3) * 4; const float4 a = *(const float4*)(A + (size_t)(m0 + r) * lda + k0 + kq);
              As[kq + 0][r] = a.x; As[kq + 1][r] = a.y; As[kq + 2][r] = a.z; As[kq + 3][r] = a.w; }
            { const int kr = tid >> 5, nq = (tid & 31) * 4; *(float4*)&Bs[kr][nq] = *(const float4*)(B + (size_t)(k0 + kr) * ldb + n0 + nq); }
            __syncthreads();
#pragma unroll
            for (int k = 0; k < 16; ++k) {
                const float4 a0 = *(const float4*)&As[k][ty * 8], a1 = *(const float4*)&As[k][ty * 8 + 4], b = *(const float4*)&Bs[k][tx * 4];
                const float av[8] = {a0.x, a0.y, a0.z, a0.w, a1.x, a1.y, a1.z, a1.w}; const float bv[4] = {b.x, b.y, b.z, b.w};
#pragma unroll
                for (int i = 0; i < 8; ++i)
#pragma unroll
                    for (int j = 0; j < 4; ++j) acc[i][j] = fmaf(av[i], bv[j], acc[i][j]);
            }
            __syncthreads();
        }
#pragma unroll
        for (int i = 0; i < 8; ++i)
#pragma unroll
            for (int j = 0; j < 4; ++j) epi(m0 + ty * 8 + i, n0 + tx * 4 + j, acc[i][j]);
    }
}

__device__ __forceinline__ float log_sigmoid_f(float x) { return fminf(x, 0.f) - log1pf(expf(-fabsf(x))); }
__device__ __forceinline__ float sigmoid_f(float x) { return 1.f / (1.f + expf(-x)); }

__device__ void sb_attn_naive(const float* proj, float* osb, int gw, int ngw, int lane) {
    for (int u = gw; u < 2 * 8 * (SEQ / 64); u += ngw) {
        const int qb = (SEQ / 64 - 1) - (u / 16), bh = u % 16, b = bh / 8, h = bh % 8;
        const int t = qb * 64 + lane;
        const float* prow = proj + (size_t)(b * SEQ) * INW;
        float q[64], acc[64];
#pragma unroll
        for (int d = 0; d < 64; ++d) { q[d] = prow[(size_t)t * INW + C_QSB + h * 64 + d] * 0.125f; acc[d] = 0.f; }
        float cum = 0.f;
        for (int s = qb * 64 + 62; s >= 0; --s) {
            const float* kr = prow + (size_t)s * INW + C_KSB + h * 64;
            const float* vr = prow + (size_t)s * INW + C_VSB + h * 64;
            float z = 0.f;
#pragma unroll
            for (int d = 0; d < 64; ++d) z = fmaf(q[d], kr[d], z);
            const bool before = s < t;
            const float lk = log_sigmoid_f(-z);
            const float w = before ? expf(log_sigmoid_f(z) + cum) : 0.f;
            cum += before ? lk : 0.f;
#pragma unroll
            for (int d = 0; d < 64; ++d) acc[d] = fmaf(w, vr[d], acc[d]);
        }
        float* o = osb + (size_t)(b * SEQ + t) * 512 + h * 64;
#pragma unroll
        for (int d = 0; d < 64; ++d) o[d] = acc[d];
    }
}

__device__ void bias_table(const float* rel_bias, float* tab, int gtid, int gsize) {
    for (int i = gtid; i < 12 * 129; i += gsize) {
        const int hh = i / 129, m = i % 129, g = hh / 4; const int dil = (g == 0) ? 1 : (g == 1) ? 4 : 16;
        const int dist = m * dil; int bucket;
        if (dist < 16) bucket = dist;
        else { const float dd = (float)dist; int large = 16 + (int)(logf(dd / 16.f) / 4.852030263919617f * 16.f); bucket = large < 31 ? large : 31; }
        tab[i] = rel_bias[bucket * 12 + hh];
    }
}

__device__ void dil_attn_naive(const float* proj, const float* tab, float* odl, int gtid, int gsize) {
    for (int u = gtid; u < T * 4; u += gsize) {
        const int i = u / T, tg = u % T, b = tg / SEQ, t = tg % SEQ;
        const float* prow = proj + (size_t)(b * SEQ) * INW;
        float acc[64];
#pragma unroll
        for (int d = 0; d < 64; ++d) acc[d] = 0.f;
        float mx = -INFINITY, l = 0.f;
        for (int g = 0; g < 3; ++g) {
            const int dil = (g == 0) ? 1 : (g == 1) ? 4 : 16, hh = g * 4 + i;
            float q[64];
#pragma unroll
            for (int d = 0; d < 64; ++d) q[d] = prow[(size_t)t * INW + C_QDL + hh * 64 + d] * 0.125f;
            for (int m = 0; m <= 128; ++m) {
                const int s = t - m * dil; if (s < 0) break;
                const float* kr = prow + (size_t)s * INW + C_KDL + hh * 64;
                const float* vr = prow + (size_t)s * INW + C_VDL + hh * 64;
                float z = 0.f;
#pragma unroll
                for (int d = 0; d < 64; ++d) z = fmaf(q[d], kr[d], z);
                z += tab[hh * 129 + m];
                if (z > mx) { const float f = expf(mx - z); l *= f;
#pragma unroll
                    for (int d = 0; d < 64; ++d) acc[d] *= f;
                    mx = z; }
                const float p = expf(z - mx); l += p;
#pragma unroll
                for (int d = 0; d < 64; ++d) acc[d] = fmaf(p, vr[d], acc[d]);
            }
        }
        const float inv = 1.f / l;
        float* o = odl + (size_t)tg * 256 + i * 64;
#pragma unroll
        for (int d = 0; d < 64; ++d) o[d] = acc[d] * inv;
    }
}

__device__ void route_tokens(const float* logits, const float* rbias, int* cnt, int2* list, int gw, int ngw, int lane) {
    for (int t = gw; t < T; t += ngw) {
        const float4 lg = ((const float4*)(logits + (size_t)t * NEXP))[lane];
        const float4 rb = ((const float4*)rbias)[lane];
        float sc[4] = {sigmoid_f(lg.x), sigmoid_f(lg.y), sigmoid_f(lg.z), sigmoid_f(lg.w)};
        float v[4] = {sc[0] + rb.x, sc[1] + rb.y, sc[2] + rb.z, sc[3] + rb.w};
        float m1 = -INFINITY, m2 = -INFINITY;
#pragma unroll
        for (int j = 0; j < 4; ++j) { if (v[j] > m1) { m2 = m1; m1 = v[j]; } else if (v[j] > m2) m2 = v[j]; }
#pragma unroll
        for (int o = 1; o < 8; o <<= 1) { const float b1 = __shfl_xor(m1, o), b2 = __shfl_xor(m2, o);
            const float n1 = fmaxf(m1, b1), n2 = fmaxf(fminf(m1, b1), fmaxf(m2, b2)); m1 = n1; m2 = n2; }
        const float gs = m1 + m2; const int grp = lane >> 3;
        int rank = 0;
#pragma unroll
        for (int g2 = 0; g2 < 8; ++g2) { const float o = __shfl(gs, g2 * 8); rank += (o > gs || (o == gs && g2 < grp)) ? 1 : 0; }
        const bool allowed = rank < 4;
#pragma unroll
        for (int j = 0; j < 4; ++j) if (!allowed) v[j] = -INFINITY;
        float wsel = 0.f; int esel = 0; float wsum = 0.f;
#pragma unroll
        for (int k = 0; k < TOPK; ++k) {
            float bv = v[0]; int bj = 0;
#pragma unroll
            for (int j = 1; j < 4; ++j) if (v[j] > bv) { bv = v[j]; bj = j; }
            int bi = lane * 4 + bj; float rv = bv; int ri = bi;
#pragma unroll
            for (int o = 1; o < 64; o <<= 1) { const float ov = __shfl_xor(rv, o); const int oi = __shfl_xor(ri, o);
                if (ov > rv || (ov == rv && oi < ri)) { rv = ov; ri = oi; } }
            float s_w = 0.f;
            if ((ri >> 2) == lane) { const int j = ri & 3;
#pragma unroll
                for (int jj = 0; jj < 4; ++jj) if (jj == j) { s_w = sc[jj]; v[jj] = -INFINITY; } }
            s_w = __shfl(s_w, ri >> 2);
            wsum += s_w;
            if (lane == k) { wsel = s_w; esel = ri; }
        }
        if (lane < TOPK) {
            const float w = wsel / wsum * 2.5f;
            const int pos = atomicAdd(&cnt[esel], 1);
            list[(size_t)esel * T + pos] = make_int2(t * 8 + lane, __float_as_int(w));
        }
    }
}

__device__ void expert_chunk(const P& p, const float* h1, float* y, int e, int c0, int n, const int2* lst, float* smem) {
    float* xs = smem;
    float* hs = smem + 16 * 1024;
    __shared__ int s_slot[16]; __shared__ float s_w[16];
    const int tid = threadIdx.x;
    const float *wg, *wu, *wd;
    if (e < NEXP) { wg = p.w_gate_e + (size_t)e * D * EH; wu = p.w_up_e + (size_t)e * D * EH; wd = p.w_down_e + (size_t)e * EH * D; }
    else { wg = p.w_gate_s; wu = p.w_up_s; wd = p.w_down_s; }
    if (tid < 16) { int slot = -1; float w = 0.f;
        if (tid < n) { if (e < NEXP) { const int2 en = lst[c0 + tid]; slot = en.x; w = __int_as_float(en.y); } else { slot = (c0 + tid) * 8; w = 1.f; } }
        s_slot[tid] = slot; s_w[tid] = w; }
    __syncthreads();
    for (int i = tid; i < 16 * 256; i += NTHR) { const int r = i >> 8, c4 = i & 255; const int slot = s_slot[r];
        float4 v = make_float4(0.f, 0.f, 0.f, 0.f); if (slot >= 0) v = ((const float4*)(h1 + (size_t)(slot >> 3) * D))[c4];
        ((float4*)xs)[i] = v; }
    __syncthreads();
    { const int j = tid & 255, half = tid >> 8; float ga[8], ua[8];
#pragma unroll
      for (int r = 0; r < 8; ++r) { ga[r] = 0.f; ua[r] = 0.f; }
      for (int d = 0; d < D; ++d) { const float g = wg[(size_t)d * EH + j], u = wu[(size_t)d * EH + j];
#pragma unroll
          for (int r = 0; r < 8; ++r) { const float xv = xs[(half * 8 + r) * 1024 + d]; ga[r] = fmaf(xv, g, ga[r]); ua[r] = fmaf(xv, u, ua[r]); } }
#pragma unroll
      for (int r = 0; r < 8; ++r) { const float g = ga[r]; hs[(half * 8 + r) * 256 + j] = g * sigmoid_f(g) * ua[r]; } }
    __syncthreads();
    { float acc[16][2];
#pragma unroll
      for (int r = 0; r < 16; ++r) { acc[r][0] = 0.f; acc[r][1] = 0.f; }
      for (int j = 0; j < EH; ++j) { const float w0 = wd[(size_t)j * D + tid], w1 = wd[(size_t)j * D + tid + 512];
#pragma unroll
          for (int r = 0; r < 16; ++r) { const float hv = hs[r * 256 + j]; acc[r][0] = fmaf(hv, w0, acc[r][0]); acc[r][1] = fmaf(hv, w1, acc[r][1]); } }
#pragma unroll
      for (int r = 0; r < 16; ++r) { const int slot = s_slot[r]; if (slot >= 0) { const float w = s_w[r];
          const int tok = slot >> 3, k = (e < NEXP) ? (slot & 7) : 8;
          float* yo = y + ((size_t)tok * 9 + k) * D; yo[tid] = w * acc[r][0]; yo[tid + 512] = w * acc[r][1]; } } }
    __syncthreads();
}

__device__ void final_rows(const float* h1, const float* y, const float* g, const float* b, float* out, int gw, int ngw, int lane) {
    for (int m = gw; m < T; m += ngw) {
        float4 v[4]; float s = 0.f;
#pragma unroll
        for (int j = 0; j < 4; ++j) { const float4 hv = ((const float4*)(h1 + (size_t)m * D))[lane + 64 * j];
            float4 a = make_float4(0.f, 0.f, 0.f, 0.f);
            for (int k = 0; k < 9; ++k) { const float4 yv = ((const float4*)(y + ((size_t)m * 9 + k) * D))[lane + 64 * j]; a.x += yv.x; a.y += yv.y; a.z += yv.z; a.w += yv.w; }
            v[j].x = ALPHA * hv.x + a.x; v[j].y = ALPHA * hv.y + a.y; v[j].z = ALPHA * hv.z + a.z; v[j].w = ALPHA * hv.w + a.w;
            s += (v[j].x + v[j].y) + (v[j].z + v[j].w); }
        const float mean = wave_sum(s) * (1.f / D); float s2 = 0.f;
#pragma unroll
        for (int j = 0; j < 4; ++j) { v[j].x -= mean; v[j].y -= mean; v[j].z -= mean; v[j].w -= mean; s2 += (v[j].x * v[j].x + v[j].y * v[j].y) + (v[j].z * v[j].z + v[j].w * v[j].w); }
        const float rstd = rsqrtf(wave_sum(s2) * (1.f / D) + LN_EPS);
        float4* o = (float4*)(out + (size_t)m * D) + lane;
#pragma unroll
        for (int j = 0; j < 4; ++j) { const float4 gg = ((const float4*)g)[lane + 64 * j], bb = ((const float4*)b)[lane + 64 * j];
            float4 r; r.x = v[j].x * rstd * gg.x + bb.x; r.y = v[j].y * rstd * gg.y + bb.y; r.z = v[j].z * rstd * gg.z + bb.z; r.w = v[j].w * rstd * gg.w + bb.w; o[64 * j] = r; }
    }
}

template <int phase> __global__ void __launch_bounds__(NTHR) phase_kernel(P p) {
    extern __shared__ __attribute__((aligned(16))) float smem[];
    const int tid = threadIdx.x, lane = tid & 63, wave = tid >> 6;
    const int gw = blockIdx.x * NWV + wave, ngw = gridDim.x * NWV;
    const int gtid = blockIdx.x * NTHR + tid, gsize = gridDim.x * NTHR;
    float* h = (float*)(p.ws + WS_H); float* proj = (float*)(p.ws + WS_PROJ); float* osb = (float*)(p.ws + WS_OSB); float* odl = (float*)(p.ws + WS_ODL);
    float* merged = (float*)(p.ws + WS_MERGED); float* y = (float*)(p.ws + WS_Y); float* logits = (float*)(p.ws + WS_LOGITS);
    int2* list = (int2*)(p.ws + WS_LIST); int* cnt = (int*)(p.ws + WS_CNT); float* tab = (float*)(p.ws + WS_BIAS);
    switch (phase) {
    case 0: ln_rows(p.x, h, p.ln_in_g, p.ln_in_b, gw, ngw, lane); bias_table(p.rel_bias, tab, gtid, gsize);
            for (int i = gtid; i < NEXP; i += gsize) cnt[i] = 0; break;
    case 1: gemm_f32(h, D, p.w_in, INW, T, INW, D, smem, [=](int r, int c, float v) { proj[(size_t)r * INW + c] = v; }); break;
    case 2: sb_attn_naive(proj, osb, gw, ngw, lane); break;
    case 3: dil_attn_naive(proj, tab, odl, gtid, gsize); break;
    case 4: { const float* bg = p.b_gate; gemm_f32(osb, 512, p.w_br_sb, D, T, D, 512, smem, [=](int r, int c, float v) { merged[(size_t)r * D + c] = sigmoid_f(proj[(size_t)r * INW + C_GSB + c] + bg[c]) * v; }); } break;
    case 5: { const float* bg = p.b_gate; gemm_f32(odl, 256, p.w_br_dil, D, T, D, 256, smem, [=](int r, int c, float v) { merged[(size_t)r * D + c] += sigmoid_f(proj[(size_t)r * INW + C_GDL + c] + bg[D + c]) * v; }); } break;
    case 6: gemm_f32(merged, D, p.w_out, D, T, D, D, smem, [=](int r, int c, float v) { h[(size_t)r * D + c] = ALPHA * h[(size_t)r * D + c] + v; }); break;
    case 7: ln_rows(h, h, p.ln1_g, p.ln1_b, gw, ngw, lane); break;
    case 8: gemm_f32(h, D, p.w_router, NEXP, T, NEXP, D, smem, [=](int r, int c, float v) { logits[(size_t)r * NEXP + c] = v; }); break;
    case 9: route_tokens(logits, p.router_bias, cnt, list, gw, ngw, lane); break;
    case 10: {
        for (int e = blockIdx.x; e < NEXP; e += gridDim.x) { const int n = cnt[e];
            for (int c0 = 0; c0 < n; c0 += 16) expert_chunk(p, h, y, e, c0, (n - c0) < 16 ? (n - c0) : 16, list + (size_t)e * T, smem); }
        for (int c = blockIdx.x; c < T / 16; c += gridDim.x) expert_chunk(p, h, y, NEXP, c * 16, 16, nullptr, smem);
    } break;
    case 11: final_rows(h, y, p.ln2_g, p.ln2_b, p.out, gw, ngw, lane); break;
    }
}

extern "C" void kernel_launch(void* const* d_in, const int* in_sizes, int n_in, void* d_out, int out_size, void* d_ws, size_t ws_size, hipStream_t stream) {
    if (n_in != 21 || ws_size < WS_END || out_size != T * D) { fprintf(stderr, "kernel_launch: unexpected shapes (n_in %d ws %zu out %d)\n", n_in, ws_size, out_size); return; }
    P p{};
    const float** f = (const float**)&p;
    for (int i = 0; i < 21; ++i) f[i] = (const float*)d_in[i];
    p.out = (float*)d_out; p.ws = (unsigned char*)d_ws;
#define LAUNCH(ph) do { (void)hipFuncSetAttribute((const void*)phase_kernel<ph>, hipFuncAttributeMaxDynamicSharedMemorySize, 96 * 1024); \
        hipLaunchKernelGGL(phase_kernel<ph>, dim3(256), dim3(NTHR), 96 * 1024, stream, p); } while (0)
    LAUNCH(0); LAUNCH(1); LAUNCH(2); LAUNCH(3); LAUNCH(4); LAUNCH(5); LAUNCH(6); LAUNCH(7); LAUNCH(8); LAUNCH(9); LAUNCH(10); LAUNCH(11);
}
```
